# Optimizing an MI355X kernel written in HIP

```python
import jax, jax.numpy as jnp
from jax import lax
import numpy as np

D_MODEL = 2048
BATCH = 8
SEQ = 4096
DEPTH = 2

HEAD_DIM = 64
MOBA_HEADS = 8
MOBA_BLOCK = 256
MOBA_TOPK = 3
MOBA_QCHUNK = 32
SB_HEADS = 8
SB_QBLOCK = 128
SWA_HEADS = 8
SWA_KV_HEADS = 2
SWA_WINDOW = 128
CONV_CH = 512
CONV_K = 3
D_FF = 5632
N_BRANCH = 4
EPS = 1e-6

MOBA_W = MOBA_HEADS * HEAD_DIM
SB_W = SB_HEADS * HEAD_DIM
SWA_QW = SWA_HEADS * HEAD_DIM
SWA_KVW = SWA_KV_HEADS * HEAD_DIM
BRANCH_W = 512
GATE_W = N_BRANCH * D_MODEL
IN_COLS = 3 * MOBA_W + 3 * SB_W + SWA_QW + 2 * SWA_KVW + 3 * CONV_CH + GATE_W

kernel_name = "hybrid_parallel_moba_stickbreak_swa_conv_macaron"


def _in_proj_splits():
    widths = [MOBA_W, MOBA_W, MOBA_W, SB_W, SB_W, SB_W, SWA_QW, SWA_KVW, SWA_KVW,
              CONV_CH, CONV_CH, CONV_CH]
    return [int(v) for v in np.cumsum(widths)]


def rms_norm(x, g):
    xf = x.astype(jnp.float32)
    y = xf * lax.rsqrt(jnp.mean(xf * xf, axis=-1, keepdims=True) + EPS)
    return (y * g.astype(jnp.float32)).astype(x.dtype)


def swiglu(x, w1, w3, w2):
    return (jax.nn.silu(x @ w1) * (x @ w3)) @ w2


def alibi_slopes(n):
    return 2.0 ** (-8.0 * jnp.arange(1, n + 1, dtype=jnp.float32) / n)


def moba_attention(q, k, v, slopes):
    bsz, seq, nh, dh = q.shape
    L = MOBA_BLOCK
    nb = -(-seq // L)
    pad = nb * L - seq
    n_sel = min(MOBA_TOPK, nb)
    qcl = MOBA_QCHUNK
    n_chunks = seq // qcl
    scale = dh ** -0.5
    q = q.transpose(0, 2, 1, 3)
    k = jnp.pad(k.transpose(0, 2, 1, 3), ((0, 0), (0, 0), (0, pad), (0, 0)))
    v = jnp.pad(v.transpose(0, 2, 1, 3), ((0, 0), (0, 0), (0, pad), (0, 0)))
    k_blocks = k.reshape(bsz, nh, nb, L, dh)
    v_blocks = v.reshape(bsz, nh, nb, L, dh)
    k_mean = jnp.mean(k_blocks.astype(jnp.float32), axis=3)
    gate = jnp.einsum('bhsd,bhnd->bhsn', q.astype(jnp.float32), k_mean)
    q_block = jnp.arange(seq) // L
    fully_past = jnp.arange(nb)[None, :] < q_block[:, None]
    gate = jnp.where(fully_past, gate, -jnp.inf)
    _, sel = lax.top_k(gate, n_sel)
    q_chunks = q.reshape(bsz, nh, n_chunks, qcl, dh).transpose(2, 0, 1, 3, 4)
    sel_chunks = sel.reshape(bsz, nh, n_chunks, qcl, n_sel).transpose(2, 0, 1, 3, 4)
    gather_blocks = jax.vmap(jax.vmap(lambda blocks, idx: blocks[idx]))

    def attend_chunk(args):
        c, q_c, sel_c = args
        t = c * qcl + jnp.arange(qcl)
        own = (c * qcl) // L
        k_own = lax.dynamic_slice_in_dim(k, own * L, L, axis=2)
        v_own = lax.dynamic_slice_in_dim(v, own * L, L, axis=2)
        d_own = t[:, None] - (own * L + jnp.arange(L))[None, :]
        lg_own = (jnp.einsum('bhqd,bhkd->bhqk', q_c, k_own,
                             preferred_element_type=jnp.float32) * scale
                  - slopes[:, None, None] * d_own)
        lg_own = jnp.where(d_own >= 0, lg_own, -jnp.inf)
        k_sel = gather_blocks(k_blocks, sel_c)
        v_sel = gather_blocks(v_blocks, sel_c)
        d_sel = t[:, None, None] - (sel_c[..., None] * L + jnp.arange(L))
        lg_sel = (jnp.einsum('bhqd,bhqrkd->bhqrk', q_c, k_sel,
                             preferred_element_type=jnp.float32) * scale
                  - slopes[:, None, None, None] * d_sel)
        keep = jnp.arange(n_sel) < own
        lg_sel = jnp.where(keep[:, None], lg_sel, -jnp.inf).reshape(bsz, nh, qcl, n_sel * L)
        p = jax.nn.softmax(jnp.concatenate([lg_sel, lg_own], axis=-1), axis=-1).astype(v.dtype)
        p_sel = p[..., :n_sel * L].reshape(bsz, nh, qcl, n_sel, L)
        p_own = p[..., n_sel * L:]
        return (jnp.einsum('bhqrk,bhqrkd->bhqd', p_sel, v_sel)
                + jnp.einsum('bhqk,bhkd->bhqd', p_own, v_own))

    out = lax.map(attend_chunk, (jnp.arange(n_chunks), q_chunks, sel_chunks))
    return out.transpose(1, 0, 3, 2, 4).reshape(bsz, seq, nh * dh)


def stick_breaking_attention(q, k, v):
    bsz, seq, nh, dh = q.shape
    scale = dh ** -0.5
    q = q.transpose(0, 2, 1, 3)
    k = k.transpose(0, 2, 1, 3)
    v = v.transpose(0, 2, 1, 3)
    outs = []
    for qb in range(seq // SB_QBLOCK):
        t0 = qb * SB_QBLOCK
        kl = t0 + SB_QBLOCK
        z = jnp.einsum('bhqd,bhkd->bhqk', q[:, :, t0:kl], k[:, :, :kl],
                       preferred_element_type=jnp.float32) * scale
        t = t0 + jnp.arange(SB_QBLOCK)
        causal = jnp.arange(kl)[None, :] < t[:, None]
        log_1m_beta = jnp.where(causal, jax.nn.log_sigmoid(-z), 0.0)
        after = lax.cumsum(log_1m_beta, axis=3, reverse=True) - log_1m_beta
        a = jnp.where(causal, jnp.exp(jax.nn.log_sigmoid(z) + after), 0.0)
        outs.append(jnp.einsum('bhqk,bhkd->bhqd', a.astype(v.dtype), v[:, :, :kl]))
    o = jnp.concatenate(outs, axis=2)
    return o.transpose(0, 2, 1, 3).reshape(bsz, seq, nh * dh)


def sliding_window_gqa(q, k, v, sinks, slopes):
    bsz, seq, nq, dh = q.shape
    nkv = k.shape[2]
    grp = nq // nkv
    W = SWA_WINDOW
    nblk = seq // W
    scale = dh ** -0.5
    qb = q.reshape(bsz, nblk, W, nkv, grp, dh)

    def with_prev(x):
        xb = x.reshape(bsz, nblk, W, nkv, dh)
        prev = jnp.pad(xb, ((0, 0), (1, 0), (0, 0), (0, 0), (0, 0)))[:, :-1]
        return jnp.concatenate([prev, xb], axis=2)

    kb = with_prev(k)
    vb = with_prev(v)
    dist = jnp.arange(W)[:, None] + W - jnp.arange(2 * W)[None, :]
    key_pos = (jnp.arange(nblk)[:, None] - 1) * W + jnp.arange(2 * W)[None, :]
    valid = (dist >= 0)[None] & (dist < W)[None] & (key_pos >= 0)[:, None, :]
    slope = slopes.reshape(nkv, grp)[None, None, :, :, None, None]
    logits = (jnp.einsum('bnqhgd,bnkhd->bnhgqk', qb, kb,
                         preferred_element_type=jnp.float32) * scale - slope * dist)
    logits = jnp.where(valid[None, :, None, None], logits, -jnp.inf)
    sink = sinks.astype(jnp.float32).reshape(nkv, grp)[None, None, :, :, None, None]
    m = jnp.maximum(jnp.max(logits, axis=-1, keepdims=True), sink)
    e = jnp.exp(logits - m)
    p = e / (jnp.sum(e, axis=-1, keepdims=True) + jnp.exp(sink - m))
    out = jnp.einsum('bnhgqk,bnkhd->bnqhgd', p.astype(v.dtype), vb)
    return out.reshape(bsz, seq, nq * dh)


def short_gated_conv(b_gate, c_gate, h, conv_w):
    u = c_gate * h
    y = lax.conv_general_dilated(u, conv_w, window_strides=(1,),
                                 padding=((CONV_K - 1, 0),),
                                 dimension_numbers=('NWC', 'WIO', 'NWC'),
                                 feature_group_count=u.shape[-1])
    return b_gate * y


def hybrid_mixer(xn, w_in, conv_w, sinks, w_branch, w_out):
    bsz, seq, _ = xn.shape
    proj = xn @ w_in
    (qa, ka, va, qb, kb, vb, qc, kc, vc, bg, cg, hd, gates) = jnp.split(
        proj, _in_proj_splits(), axis=-1)

    def heads(t, n):
        return t.reshape(bsz, seq, n, HEAD_DIM)

    slopes = alibi_slopes(SWA_HEADS + MOBA_HEADS)
    swa_slopes = slopes[:SWA_HEADS]
    moba_slopes = slopes[SWA_HEADS:]
    y_a = moba_attention(heads(qa, MOBA_HEADS), heads(ka, MOBA_HEADS),
                         heads(va, MOBA_HEADS), moba_slopes)
    y_b = stick_breaking_attention(heads(qb, SB_HEADS), heads(kb, SB_HEADS),
                                   heads(vb, SB_HEADS))
    y_c = sliding_window_gqa(heads(qc, SWA_HEADS), heads(kc, SWA_KV_HEADS),
                             heads(vc, SWA_KV_HEADS), sinks, swa_slopes)
    y_d = short_gated_conv(bg, cg, hd, conv_w)
    g = gates.reshape(bsz, seq, N_BRANCH, D_MODEL)
    branches = (y_a, y_b, y_c, y_d)
    merged = jax.nn.sigmoid(g[:, :, 0]) * (branches[0] @ w_branch[0])
    for n in range(1, N_BRANCH):
        merged = merged + jax.nn.sigmoid(g[:, :, n]) * (branches[n] @ w_branch[n])
    return merged @ w_out


def setup_inputs(seed: int = 0) -> dict:
    key = jax.random.key(seed)
    ks = jax.random.split(key, 16)

    def nrm(k, shape, scale):
        return jax.random.normal(k, shape, jnp.float32) * scale

    def gain(k, shape):
        return 1.0 + 0.02 * jax.random.normal(k, shape, jnp.float32)

    return {
        "x": nrm(ks[0], (BATCH, SEQ, D_MODEL), 1.0),
        "ffn1_norm": gain(ks[1], (DEPTH, D_MODEL)),
        "ffn1_w1": nrm(ks[2], (DEPTH, D_MODEL, D_FF), D_MODEL ** -0.5),
        "ffn1_w3": nrm(ks[3], (DEPTH, D_MODEL, D_FF), D_MODEL ** -0.5),
        "ffn1_w2": nrm(ks[4], (DEPTH, D_FF, D_MODEL), D_FF ** -0.5),
        "mix_norm": gain(ks[5], (DEPTH, D_MODEL)),
        "w_in": nrm(ks[6], (DEPTH, D_MODEL, IN_COLS), D_MODEL ** -0.5),
        "conv_w": nrm(ks[7], (DEPTH, CONV_K, 1, CONV_CH), CONV_K ** -0.5),
        "attn_sinks": nrm(ks[8], (DEPTH, SWA_HEADS), 1.0),
        "w_branch": nrm(ks[9], (DEPTH, N_BRANCH, BRANCH_W, D_MODEL), BRANCH_W ** -0.5),
        "w_out": nrm(ks[10], (DEPTH, D_MODEL, D_MODEL), D_MODEL ** -0.5),
        "ffn2_norm": gain(ks[11], (DEPTH, D_MODEL)),
        "ffn2_w1": nrm(ks[12], (DEPTH, D_MODEL, D_FF), D_MODEL ** -0.5),
        "ffn2_w3": nrm(ks[13], (DEPTH, D_MODEL, D_FF), D_MODEL ** -0.5),
        "ffn2_w2": nrm(ks[14], (DEPTH, D_FF, D_MODEL), D_FF ** -0.5),
        "final_norm": gain(ks[15], (D_MODEL,)),
    }


def reference(x, ffn1_norm, ffn1_w1, ffn1_w3, ffn1_w2, mix_norm, w_in, conv_w,
              attn_sinks, w_branch, w_out, ffn2_norm, ffn2_w1, ffn2_w3, ffn2_w2,
              final_norm):
    h = x
    for l in range(DEPTH):
        h = h + 0.5 * swiglu(rms_norm(h, ffn1_norm[l]), ffn1_w1[l], ffn1_w3[l], ffn1_w2[l])
        h = h + hybrid_mixer(rms_norm(h, mix_norm[l]), w_in[l], conv_w[l],
                             attn_sinks[l], w_branch[l], w_out[l])
        h = h + 0.5 * swiglu(rms_norm(h, ffn2_norm[l]), ffn2_w1[l], ffn2_w3[l], ffn2_w2[l])
    return rms_norm(h, final_norm)
```

```cpp
#include <hip/hip_runtime.h>
#include <cstdio>
#include <cstdint>

#ifndef MK_PER_PHASE
#define MK_PER_PHASE 0
#endif

namespace pg8 {
#define PG8_LAS __attribute__((address_space(3)))
typedef unsigned short bf16_t;
typedef short bf16x8 __attribute__((ext_vector_type(8)));
typedef float f32x4 __attribute__((ext_vector_type(4)));
typedef float f32x2 __attribute__((ext_vector_type(2)));
typedef unsigned u32x4 __attribute__((ext_vector_type(4)));
typedef unsigned u32x2 __attribute__((ext_vector_type(2)));
constexpr int BM = 256, BK = 64, HALF = 128, HTB = HALF * BK * 2  , STAGE_BYTES = 8 * HTB, NXCD = 8, WGM = 8;

__host__ __device__ __forceinline__ int lds_byte(int r, int c) { const int st = (r >> 4) * 2 + (c >> 5), rr = r & 15, cc = c & 31, ob = rr * 64 + cc * 2; return st * 1024 + (ob ^ (((ob >> 9) & 1) << 5)); }
__host__ __device__ __forceinline__ void stage_rc(int b, int& R, int& C) { const int st = b / 1024, sb = b % 1024, swz = sb ^ (((sb >> 9) & 1) << 5); R = (st >> 1) * 16 + swz / 64; C = (st & 1) * 32 + (swz % 64) / 2; }
__host__ __device__ __forceinline__ int perm32(int rho) { const int n = rho >> 4, i = rho & 15; return 8 * (i >> 2) + 4 * n + (i & 3); }

struct Unit { int pm, pn; };
struct Gemm { const bf16_t* A; const bf16_t* Bt; int M, N, K, lda, adiv, amul; };

struct StaticOrder {
    int nM, nN, nwg, G, c;
    __device__ void init(int M, int N, int G_, int c_) { nM = M / BM; nN = N / BM; nwg = nM * nN; G = G_; c = c_; }
    __device__ bool next(int i, Unit& u) const {
        const long L = (long)i * G + c; if (L >= nwg) return false;
        int wgid = (int)L; { const int q = nwg / NXCD, r = nwg % NXCD, xcd = wgid % NXCD, off = wgid / NXCD; wgid = (xcd < r ? xcd * (q + 1) : r * (q + 1) + (xcd - r) * q) + off; }
        const int nig = WGM * nN, gid = wgid / nig, fm = gid * WGM, gsz = (nM - fm) < WGM ? (nM - fm) : WGM;
        u.pm = fm + ((wgid % nig) % gsz); u.pn = (wgid % nig) / gsz; return true;
    }
};

__device__ __forceinline__ unsigned cvt_pk_bf16(float lo, float hi) { unsigned r; asm volatile("v_cvt_pk_bf16_f32 %0, %1, %2" : "=v"(r) : "v"(lo), "v"(hi)); return r; }
__device__ __forceinline__ float sigmoid_f(float x) { return __builtin_amdgcn_rcpf(1.0f + __builtin_amdgcn_exp2f(-1.4426950408889634f * x)); }
__device__ __forceinline__ float bf_lo(unsigned w) { return __uint_as_float(w << 16); }
__device__ __forceinline__ float bf_hi(unsigned w) { return __uint_as_float(w & 0xffff0000u); }


struct EpiSwiglu {
    static constexpr bool PERM = true;
    bf16_t* U; int ldc;
    __device__ __forceinline__ void operator()(const f32x4 (&acc)[2][2][4][2], const Unit& u, int wr, int wc, int fr, int fq) const {
        const int row0 = u.pm * BM + wr * 64 + fr, col0 = u.pn * HALF + wc * 32 + 8 * fq;
#pragma unroll
        for (int ai = 0; ai < 2; ++ai)
#pragma unroll
            for (int m = 0; m < 4; ++m) { bf16_t* rowp = U + (size_t)(row0 + ai * HALF + m * 16) * ldc + col0;
                f32x4 v0, v1;
#pragma unroll
                for (int j = 0; j < 4; ++j) { const float a0 = acc[ai][0][m][0][j], a1 = acc[ai][0][m][1][j];
                    v0[j] = a0 * sigmoid_f(a0) * acc[ai][1][m][0][j]; v1[j] = a1 * sigmoid_f(a1) * acc[ai][1][m][1][j]; }
                u32x4 w; w.x = cvt_pk_bf16(v0[0], v0[1]); w.y = cvt_pk_bf16(v0[2], v0[3]); w.z = cvt_pk_bf16(v1[0], v1[1]); w.w = cvt_pk_bf16(v1[2], v1[3]);
                *(u32x4*)rowp = w; }
    }
};
struct EpiResid {
    static constexpr bool PERM = false;
    const float* res; float* out; int ldc; float scale;
    __device__ __forceinline__ void operator()(const f32x4 (&acc)[2][2][4][2], const Unit& u, int wr, int wc, int fr, int fq) const {
        const int row0 = u.pm * BM + wr * 64 + fr, col0 = u.pn * BM + wc * 32 + 4 * fq;
#pragma unroll
        for (int ai = 0; ai < 2; ++ai)
#pragma unroll
            for (int m = 0; m < 4; ++m) { const size_t off = (size_t)(row0 + ai * HALF + m * 16) * ldc + col0;
#pragma unroll
                for (int bj = 0; bj < 2; ++bj)
#pragma unroll
                    for (int n = 0; n < 2; ++n) { const f32x4 r = *(const f32x4*)(res + off + bj * HALF + n * 16); *(f32x4*)(out + off + bj * HALF + n * 16) = r + acc[ai][bj][m][n] * scale; } }
    }
};
struct EpiBf16 {
    static constexpr bool PERM = true;
    bf16_t* O; int ldc; unsigned qmask; float qscale;
    __device__ __forceinline__ void operator()(const f32x4 (&acc)[2][2][4][2], const Unit& u, int wr, int wc, int fr, int fq) const {
        const int row0 = u.pm * BM + wr * 64 + fr, col0 = u.pn * BM + wc * 32 + 8 * fq;
        const float sc = ((qmask >> u.pn) & 1u) ? qscale : 1.0f;
#pragma unroll
        for (int ai = 0; ai < 2; ++ai)
#pragma unroll
            for (int m = 0; m < 4; ++m) { bf16_t* rowp = O + (size_t)(row0 + ai * HALF + m * 16) * ldc + col0;
#pragma unroll
                for (int bj = 0; bj < 2; ++bj) { const f32x4 v0 = acc[ai][bj][m][0] * sc, v1 = acc[ai][bj][m][1] * sc;
                    u32x4 w; w.x = cvt_pk_bf16(v0[0], v0[1]); w.y = cvt_pk_bf16(v0[2], v0[3]); w.z = cvt_pk_bf16(v1[0], v1[1]); w.w = cvt_pk_bf16(v1[2], v1[3]);
                    *(u32x4*)(rowp + bj * HALF) = w; } }
    }
};
struct EpiGateMerge {
    static constexpr bool PERM = false;
    const bf16_t* P; bf16_t* Mg;
    __device__ __forceinline__ void operator()(const f32x4 (&acc)[2][2][4][2], const Unit& u, int wr, int wc, int fr, int fq) const {
        const int row0 = u.pm * BM + wr * 64 + fr, col0 = u.pn * 64 + wc * 16 + 4 * fq;
#pragma unroll
        for (int ai = 0; ai < 2; ++ai)
#pragma unroll
            for (int m = 0; m < 4; ++m) { const int row = row0 + ai * HALF + m * 16; const bf16_t* prow = P + (size_t)row * 8192 + col0;
                f32x4 tot = (f32x4){0.f, 0.f, 0.f, 0.f};
#pragma unroll
                for (int bj = 0; bj < 2; ++bj)
#pragma unroll
                    for (int n = 0; n < 2; ++n) { const u32x2 pw = *(const u32x2*)(prow + (2 * bj + n) * 2048); const f32x4 g = acc[ai][bj][m][n];
                        tot[0] += sigmoid_f(g[0]) * bf_lo(pw.x); tot[1] += sigmoid_f(g[1]) * bf_hi(pw.x); tot[2] += sigmoid_f(g[2]) * bf_lo(pw.y); tot[3] += sigmoid_f(g[3]) * bf_hi(pw.y); }
                u32x2 w; w.x = cvt_pk_bf16(tot[0], tot[1]); w.y = cvt_pk_bf16(tot[2], tot[3]);
                *(u32x2*)(Mg + (size_t)row * 2048 + col0) = w; }
    }
};

template <class Epi, class Sched>
__device__ __forceinline__ void gemm_phase(PG8_LAS unsigned char* lds, const Gemm g, const Sched& S, const Epi& E, const int tid) {
    const int wid = __builtin_amdgcn_readfirstlane(tid >> 6), lane = tid & 63, wr = wid >> 2, wc = wid & 3, fr = lane & 15, fq = lane >> 4;
    const int K = g.K, nt = K / BK, lda = g.lda;
    unsigned voffA[2], voffB[2];
#pragma unroll
    for (int i = 0; i < 2; ++i) { int R, C; stage_rc(tid * 16 + i * 8192, R, C); const int Rb = Epi::PERM ? ((R & ~31) + perm32(R & 31)) : R;
        voffA[i] = (unsigned)(R * lda + C) * 2u; voffB[i] = (unsigned)(Rb * K + C) * 2u; }
    const size_t kstep = (size_t)(BK * 2);
    const size_t hstepA = (size_t)HALF * lda * 2, hstepB = (size_t)HALF * K * 2;
    const size_t tstepA = 2 * hstepA, tstepB = 2 * hstepB;
    const unsigned ldsw = (unsigned)wid * 1024u;
    const int aoff = lds_byte(wr * 64 + fr, fq * 8), boff = lds_byte(wc * 32 + fr, fq * 8);
#define PG8_SA(b, h) (((b) * 2 + (h)) * HTB)
#define PG8_SB(b, h) ((4 + (b) * 2 + (h)) * HTB)
#define PG8_STAGE(bufoff, gbase, voff) do { _Pragma("unroll") for (int _i = 0; _i < 2; ++_i) \
        __builtin_amdgcn_global_load_lds((const unsigned*)((const char*)(gbase) + (voff)[_i]), (PG8_LAS unsigned*)(lds + (bufoff) + ldsw + _i * 8192), 16, 0, 0); } while (0)
#define PG8_LDA(dst, b, h) do { _Pragma("unroll") for (int m = 0; m < 4; ++m) _Pragma("unroll") for (int k = 0; k < 2; ++k) dst[m][k] = *(const PG8_LAS bf16x8*)(lds + PG8_SA(b, h) + aoff + m * 2048 + k * 1024); } while (0)
#define PG8_LDB(dst, b, h) do { _Pragma("unroll") for (int n = 0; n < 2; ++n) _Pragma("unroll") for (int k = 0; k < 2; ++k) dst[n][k] = *(const PG8_LAS bf16x8*)(lds + PG8_SB(b, h) + boff + n * 2048 + k * 1024); } while (0)
#define PG8_MMA(ai, bj, At, Bt) do { __builtin_amdgcn_s_setprio(1); _Pragma("unroll") for (int m = 0; m < 4; ++m) _Pragma("unroll") for (int n = 0; n < 2; ++n) _Pragma("unroll") for (int k = 0; k < 2; ++k) \
        acc[ai][bj][m][n] = __builtin_amdgcn_mfma_f32_16x16x32_bf16(Bt[n][k], At[m][k], acc[ai][bj][m][n], 0, 0, 0); __builtin_amdgcn_s_setprio(0); } while (0)
#define PG8_WAIT_V(n) asm volatile("s_waitcnt vmcnt(" #n ")" ::: "memory")
#define PG8_WAIT_L(n) asm volatile("s_waitcnt lgkmcnt(" #n ")" ::: "memory")
#define PG8_BAR __builtin_amdgcn_s_barrier()
#define PG8_SCHED __builtin_amdgcn_sched_barrier(0)
#define PG8_AOFF(u_) ((g.adiv > 0) ? (size_t)((u_).pn / g.adiv) * (size_t)g.amul * 2 : (size_t)0)
    Unit cur, nxt; int ui = 0;
    if (!S.next(0, cur)) return;
    f32x4 acc[2][2][4][2];
#pragma unroll
    for (int a = 0; a < 2; ++a)
#pragma unroll
        for (int b = 0; b < 2; ++b)
#pragma unroll
            for (int m = 0; m < 4; ++m)
#pragma unroll
                for (int n = 0; n < 2; ++n) acc[a][b][m][n] = (f32x4){0.f, 0.f, 0.f, 0.f};
    bf16x8 At[4][2], B0[2][2], B1[2][2];
    const char* cA = (const char*)g.A + (size_t)cur.pm * tstepA + PG8_AOFF(cur); const char* cB = (const char*)g.Bt + (size_t)cur.pn * tstepB;
    PG8_STAGE(PG8_SB(0, 0), cB, voffB); PG8_STAGE(PG8_SB(0, 1), cB + hstepB, voffB); PG8_STAGE(PG8_SA(0, 0), cA, voffA); PG8_STAGE(PG8_SA(0, 1), cA + hstepA, voffA);
    if (wr == 1) PG8_BAR;
    PG8_WAIT_V(2); PG8_BAR;
    PG8_STAGE(PG8_SB(1, 0), cB + kstep, voffB); PG8_STAGE(PG8_SA(1, 0), cA + kstep, voffA); PG8_STAGE(PG8_SB(1, 1), cB + hstepB + kstep, voffB);
    PG8_WAIT_V(6); PG8_BAR;
    for (;;) {
        const bool has_next = S.next(ui + 1, nxt);
        const char* nA = has_next ? (const char*)g.A + (size_t)nxt.pm * tstepA + PG8_AOFF(nxt) : cA; const char* nB = has_next ? (const char*)g.Bt + (size_t)nxt.pn * tstepB : cB;
        for (int t = 0; t < nt; t += 2) {
            const bool last = (t == nt - 2);
            const char* a1 = cA + (size_t)(t + 1) * kstep;
            const char* a2 = last ? nA : cA + (size_t)(t + 2) * kstep; const char* b2 = last ? nB : cB + (size_t)(t + 2) * kstep;
            const char* a3 = a2 + kstep; const char* b3 = b2 + kstep;
            PG8_LDB(B0, 0, 0); PG8_LDB(B1, 0, 1); PG8_SCHED; PG8_LDA(At, 0, 0); PG8_STAGE(PG8_SA(1, 1), a1 + hstepA, voffA);
            PG8_WAIT_V(8); PG8_WAIT_L(0); PG8_BAR; PG8_MMA(0, 0, At, B0); PG8_MMA(0, 1, At, B1); PG8_BAR; PG8_SCHED;
            PG8_LDA(At, 0, 1); PG8_STAGE(PG8_SB(0, 0), b2, voffB); PG8_STAGE(PG8_SB(0, 1), b2 + hstepB, voffB); PG8_STAGE(PG8_SA(0, 0), a2, voffA);
            PG8_WAIT_V(8); PG8_WAIT_L(0); PG8_BAR; PG8_MMA(1, 0, At, B0); PG8_MMA(1, 1, At, B1); PG8_BAR; PG8_SCHED;
            PG8_LDB(B0, 1, 0); PG8_LDB(B1, 1, 1); PG8_SCHED; PG8_LDA(At, 1, 0); PG8_STAGE(PG8_SA(0, 1), a2 + hstepA, voffA);
            PG8_WAIT_V(8); PG8_WAIT_L(0); PG8_BAR; PG8_MMA(0, 0, At, B0); PG8_MMA(0, 1, At, B1); PG8_BAR; PG8_SCHED;
            PG8_LDA(At, 1, 1); PG8_STAGE(PG8_SB(1, 0), b3, voffB); PG8_STAGE(PG8_SB(1, 1), b3 + hstepB, voffB); PG8_STAGE(PG8_SA(1, 0), a3, voffA);
            PG8_WAIT_V(8); PG8_WAIT_L(0); PG8_BAR; PG8_MMA(1, 0, At, B0); PG8_MMA(1, 1, At, B1); PG8_BAR; PG8_SCHED;
        }
        if (wr == 0) PG8_BAR;
        E(acc, cur, wr, wc, fr, fq);
        if (!has_next) break;
#pragma unroll
        for (int a = 0; a < 2; ++a)
#pragma unroll
            for (int b = 0; b < 2; ++b)
#pragma unroll
                for (int m = 0; m < 4; ++m)
#pragma unroll
                    for (int n = 0; n < 2; ++n) acc[a][b][m][n] = (f32x4){0.f, 0.f, 0.f, 0.f};
        cur = nxt; cA = nA; cB = nB; ++ui;
        if (wr == 1) PG8_BAR;
    }
    PG8_WAIT_V(0);
    PG8_BAR;
#undef PG8_SA
#undef PG8_SB
#undef PG8_STAGE
#undef PG8_LDA
#undef PG8_LDB
#undef PG8_MMA
#undef PG8_WAIT_V
#undef PG8_WAIT_L
#undef PG8_BAR
#undef PG8_SCHED
#undef PG8_AOFF
}
}

constexpr int D_MODEL = 2048, BATCH = 8, SEQ = 4096, DEPTH = 2, D_FF = 5632;
constexpr int MTOK = BATCH * SEQ;
constexpr int QKV_W = 5376;
constexpr int GATE_W = 8192, IN_COLS = QKV_W + GATE_W;
constexpr int NCHUNK = 2, CH_ROWS = MTOK / NCHUNK, CH_B = BATCH / NCHUNK;
constexpr float RMS_EPS = 1e-6f;
constexpr float QSCALE = 0.125f * 1.4426950408889634f;
constexpr int C_QA = 0, C_KA = 512, C_VA = 1024, C_QB = 1536, C_KB = 2048, C_VB = 2560, C_QC = 3072, C_KC = 3584, C_VC = 3712, C_BG = 3840, C_CG = 4352, C_HD = 4864;
constexpr unsigned QMASK = (3u << 0) | (3u << 6) | (3u << 12);

constexpr size_t MiB = 1u << 20;
constexpr size_t WS_CTL = 0, CTL_ZERO_BYTES = 1 * MiB;
constexpr size_t WS_KMEAN = 1 * MiB;
constexpr size_t WS_W13A = 2 * MiB, WS_W13B = WS_W13A + 44 * MiB, WS_W2A = WS_W13B + 44 * MiB, WS_W2B = WS_W2A + 22 * MiB,
                 WS_WQKV = WS_W2B + 22 * MiB, WS_WG = WS_WQKV + 21 * MiB, WS_WB = WS_WG + 32 * MiB, WS_WO = WS_WB + 8 * MiB, WS_WEND = WS_WO + 8 * MiB;
constexpr size_t WS_XN = 204 * MiB;
constexpr size_t WS_BIG = 332 * MiB;
constexpr size_t WS_U = WS_BIG;
constexpr size_t WS_QKV = WS_BIG;
constexpr size_t WS_Y = WS_BIG + 168 * MiB;
constexpr size_t WS_P = WS_Y + 64 * MiB;
constexpr size_t WS_MG = WS_P + 256 * MiB;
constexpr size_t WS_END = WS_MG + 64 * MiB;
static_assert(WS_WEND <= WS_XN && WS_XN + (size_t)MTOK * 2048 * 2 <= WS_BIG && WS_U + (size_t)MTOK * D_FF * 2 <= WS_END, "d_ws map");
constexpr int CW_BAR = 4096;

constexpr int RING_BYTES = 131072;
constexpr int LDSCTL_OFF = RING_BYTES, MISC_OFF = LDSCTL_OFF + 320;
constexpr int LDS_BYTES = 147456;
constexpr int NWAVES = 8;

#define GAS __attribute__((address_space(1)))
#define LAS __attribute__((address_space(3)))
typedef unsigned short bf16;
typedef unsigned v4u __attribute__((ext_vector_type(4)));
typedef unsigned v2u __attribute__((ext_vector_type(2)));
typedef float f32x4 __attribute__((ext_vector_type(4)));
typedef float f32x16 __attribute__((ext_vector_type(16)));
typedef short bf16x8 __attribute__((ext_vector_type(8)));
typedef short v4i16 __attribute__((ext_vector_type(4)));
#define LDS_WAIT() asm volatile("s_waitcnt lgkmcnt(0)" ::: "memory")
__device__ __forceinline__ unsigned f2bf(float f) { unsigned u = __builtin_bit_cast(unsigned, f); return (u + 0x7fffu + ((u >> 16) & 1u)) >> 16; }
__device__ __forceinline__ unsigned pk2(float lo, float hi) { return f2bf(lo) | (f2bf(hi) << 16); }
__device__ __forceinline__ float bflo(unsigned w) { return __uint_as_float(w << 16); }
__device__ __forceinline__ float bfhi(unsigned w) { return __uint_as_float(w & 0xffff0000u); }

#define XB_TMO      128
#define XB_XCNT(j)  (256  + 64 * (j))
#define XB_XSUB(j)  (1280 + 64 * (j))
#define XB_XGEN(j)  (2304 + 64 * (j))
#define XB_TOP      3328
#define XB_TOPGEN   3392
#define XCD_BAR_WORDS 3456
#define XB_SPIN_CAP (1u << 18)
__device__ __forceinline__ unsigned xb_ld(unsigned* p)              { return __hip_atomic_load(p, __ATOMIC_RELAXED, __HIP_MEMORY_SCOPE_AGENT); }
__device__ __forceinline__ unsigned xb_add(unsigned* p, unsigned v) { return __hip_atomic_fetch_add(p, v, __ATOMIC_RELAXED, __HIP_MEMORY_SCOPE_AGENT); }
__device__ __forceinline__ unsigned xb_xcc_id() { return (unsigned)__builtin_amdgcn_s_getreg((3 << 11) | 20) & 0xFu; }
#define XB_SPIN(cond, bar) do { unsigned _sp = 0; while (cond) { __builtin_amdgcn_s_sleep(1); \
    if ((++_sp & 255u) == 0u) { if (xb_ld(&(bar)[XB_TMO])) break; if (_sp > XB_SPIN_CAP) { atomicAdd(&(bar)[XB_TMO], 1u); break; } } } } while (0)
struct XcdBarrier { unsigned* bar; unsigned x; volatile LAS unsigned* st; };
__device__ __forceinline__ XcdBarrier xcd_barrier_post(unsigned* bar, volatile LAS unsigned* st) {
    XcdBarrier b; b.bar = bar; b.x = xb_xcc_id(); b.st = st;
    if (threadIdx.x == 0) (void)xb_add(&bar[XB_XCNT(b.x)], 1u);
    return b;
}
__device__ __forceinline__ void xcd_barrier_complete(unsigned* bar, unsigned x, unsigned& nloc, unsigned& nx) {
    const unsigned G = gridDim.x * gridDim.y * gridDim.z;
    unsigned sum, cnt, mine, sp = 0u;
    for (;;) {
        sum = 0u; cnt = 0u; mine = 0u;
#pragma unroll
        for (unsigned j = 0; j < 16; ++j) { const unsigned c = xb_ld(&bar[XB_XCNT(j)]); sum += c; cnt += (c > 0u) ? 1u : 0u; mine = (j == x) ? c : mine; }
        if (sum == G) break;
        __builtin_amdgcn_s_sleep(1);
        if ((++sp & 255u) == 0u) { if (xb_ld(&bar[XB_TMO])) break; if (sp > XB_SPIN_CAP) { atomicAdd(&bar[XB_TMO], 1u); break; } }
    }
    nloc = mine > 0u ? mine : 1u; nx = cnt > 0u ? cnt : 1u;
}
__device__ __forceinline__ void xcd_barrier(const XcdBarrier& b) {
    asm volatile("s_waitcnt vmcnt(0)" ::: "memory");
    __syncthreads();
    if (threadIdx.x == 0) {
        unsigned* bar = b.bar;
        __builtin_amdgcn_s_waitcnt(0);
        unsigned nloc = b.st[0], nx = b.st[1];
        if (nloc == 0u) { xcd_barrier_complete(bar, b.x, nloc, nx); b.st[0] = nloc; b.st[1] = nx; }
        const unsigned old = xb_add(&bar[XB_XSUB(b.x)], 1u);
        const unsigned gen = old / nloc;
        if (old + 1u == (gen + 1u) * nloc) {
            __builtin_amdgcn_fence(__ATOMIC_RELEASE, "agent");
            asm volatile("s_waitcnt vmcnt(0)" ::: "memory");
            const unsigned og = xb_add(&bar[XB_TOP], 1u);
            const unsigned tg = og / nx;
            if (og + 1u == (tg + 1u) * nx) xb_add(&bar[XB_TOPGEN], 1u);
            else XB_SPIN(xb_ld(&bar[XB_TOPGEN]) == tg, bar);
            __builtin_amdgcn_fence(__ATOMIC_ACQUIRE, "agent");
            xb_add(&bar[XB_XGEN(b.x)], 1u);
            asm volatile("s_waitcnt vmcnt(0)" ::: "memory");
        } else {
            XB_SPIN(xb_ld(&bar[XB_XGEN(b.x)]) == gen, bar);
            __builtin_amdgcn_fence(__ATOMIC_ACQUIRE, "agent");
            asm volatile("s_waitcnt vmcnt(0)" ::: "memory");
        }
    }
    __syncthreads();
}

__device__ __forceinline__ float wave_sum(float v) {
#pragma unroll
    for (int o = 1; o < 64; o <<= 1) v += __shfl_xor(v, o);
    return v;
}
__device__ __forceinline__ const float* wsrc_col(int kind, const float* W, const float* W2, int c0, int d) {
    if (kind == 0) return W + c0 + d;
    if (kind == 1) { const int pn = d >> 8, j = d & 255; return (j < 128) ? (W + 128 * pn + j) : (W2 + 128 * pn + j - 128); }
    if (kind == 2) { const int pn = d >> 8, tc = d & 255, bj = tc >> 7, wc = (tc >> 5) & 3, n = (tc >> 4) & 1, fq = (tc >> 2) & 3, e = tc & 3;
        return W + c0 + (2 * bj + n) * 2048 + 64 * pn + 16 * wc + 4 * fq + e; }
    return W + (size_t)(d >> 11) * 512 * 2048 + (d & 2047);
}
__device__ __forceinline__ void transpose_item(int kind, const float* W, const float* W2, int c0, int ldw, int K, int nrows, bf16* WT, LAS float* scr, int item, int lane) {
    const int nblk = nrows / 32, kb = item / nblk, nb = item % nblk, k0 = 64 * kb, n0 = 32 * nb;
    const float* src = wsrc_col(kind, W, W2, c0, n0 + (lane & 31));
#pragma unroll 8
    for (int i = 0; i < 32; ++i) { const int kk = 2 * i + (lane >> 5); scr[kk * 33 + (lane & 31)] = src[(size_t)(k0 + kk) * ldw]; }
    LDS_WAIT(); asm volatile("" ::: "memory");
    const int c = lane & 7;
#pragma unroll
    for (int j = 0; j < 4; ++j) { const int n = (lane >> 3) + 8 * j; const LAS float* s = scr + (8 * c) * 33 + n;
        v4u o; o.x = pk2(s[0 * 33], s[1 * 33]); o.y = pk2(s[2 * 33], s[3 * 33]); o.z = pk2(s[4 * 33], s[5 * 33]); o.w = pk2(s[6 * 33], s[7 * 33]);
        *(GAS v4u*)(WT + (size_t)(n0 + n) * K + k0 + 8 * c) = o; }
    LDS_WAIT(); asm volatile("" ::: "memory");
}
__device__ __forceinline__ void rms_row_to_bf16(const float* xrow, const float* g, bf16* orow, int lane) {
    const GAS f32x4* xr = (const GAS f32x4*)xrow + lane; const GAS f32x4* gr = (const GAS f32x4*)g + lane;
    f32x4 v[8]; float s = 0.f;
#pragma unroll
    for (int j = 0; j < 8; ++j) { v[j] = xr[64 * j]; s += (v[j].x * v[j].x + v[j].y * v[j].y) + (v[j].z * v[j].z + v[j].w * v[j].w); }
    const float rstd = 1.0f / sqrtf(wave_sum(s) * (1.f / D_MODEL) + RMS_EPS);
    GAS unsigned long long* o8 = (GAS unsigned long long*)orow + lane;
#pragma unroll
    for (int j = 0; j < 8; ++j) { const f32x4 gg = gr[64 * j];
        o8[64 * j] = (unsigned long long)pk2(v[j].x * rstd * gg.x, v[j].y * rstd * gg.y) | ((unsigned long long)pk2(v[j].z * rstd * gg.z, v[j].w * rstd * gg.w) << 32); }
}
__device__ __forceinline__ void rms_row_to_f32(float* xrow, const float* g, int lane) {
    GAS f32x4* xr = (GAS f32x4*)xrow + lane; const GAS f32x4* gr = (const GAS f32x4*)g + lane;
    f32x4 v[8]; float s = 0.f;
#pragma unroll
    for (int j = 0; j < 8; ++j) { v[j] = xr[64 * j]; s += (v[j].x * v[j].x + v[j].y * v[j].y) + (v[j].z * v[j].z + v[j].w * v[j].w); }
    const float rstd = 1.0f / sqrtf(wave_sum(s) * (1.f / D_MODEL) + RMS_EPS);
#pragma unroll
    for (int j = 0; j < 8; ++j) { const f32x4 gg = gr[64 * j]; xr[64 * j] = v[j] * rstd * gg; }
}

namespace att {
constexpr int VRS = 144;
constexpr int PITCH = QKV_W;
typedef float f32x2_t __attribute__((ext_vector_type(2))); typedef __bf16 bf16x2_t __attribute__((ext_vector_type(2)));
__device__ __forceinline__ unsigned cvtpk(float lo, float hi) { f32x2_t v = {lo, hi}; bf16x2_t b = __builtin_convertvector(v, bf16x2_t); return __builtin_bit_cast(unsigned, b); }
__device__ __forceinline__ float ex2(float x) { return __builtin_amdgcn_exp2f(x); }
__device__ __forceinline__ float lg2(float x) { return __builtin_amdgcn_logf(x); }
struct KV { bf16x8 k[4]; v4u v[4]; };
__device__ __forceinline__ void load_kv(KV& t, const bf16* Kb, const bf16* Vb, int s0, int lane) {
    const bf16* kp = Kb + (size_t)(s0 + (lane & 31)) * PITCH + (lane >> 5) * 8;
#pragma unroll
    for (int ds = 0; ds < 4; ++ds) t.k[ds] = *(const GAS bf16x8*)(kp + ds * 16);
    const bf16* vp = Vb + (size_t)(s0 + (lane >> 3)) * PITCH + (lane & 7) * 8;
#pragma unroll
    for (int i = 0; i < 4; ++i) t.v[i] = *(const GAS v4u*)(vp + (size_t)(8 * i) * PITCH);
}
__device__ __forceinline__ void load_q(bf16x8 (&qf)[4], const bf16* Qb, int q0, int lane) {
    const bf16* qp = Qb + (size_t)(q0 + (lane & 31)) * PITCH + (lane >> 5) * 8;
#pragma unroll
    for (int ds = 0; ds < 4; ++ds) qf[ds] = *(const GAS bf16x8*)(qp + ds * 16);
}
__device__ __forceinline__ f32x16 qk_tile(const KV& t, const bf16x8 (&qf)[4]) {
    f32x16 s;
#pragma unroll
    for (int r = 0; r < 16; ++r) s[r] = 0.f;
#pragma unroll
    for (int ds = 0; ds < 4; ++ds) s = __builtin_amdgcn_mfma_f32_32x32x16_bf16(t.k[ds], qf[ds], s, 0, 0, 0);
    return s;
}
__device__ __forceinline__ void pv_tile(f32x16 (&o)[2], const KV& t, const f32x16& p, LAS unsigned char* vl, int lane) {
#pragma unroll
    for (int i = 0; i < 4; ++i) *(LAS v4u*)(vl + ((lane >> 3) + 8 * i) * VRS + (lane & 7) * 16) = t.v[i];
    const int hi = lane >> 5, q = (lane & 15) >> 2, pp = lane & 3, g = (lane >> 4) & 1;
    LAS unsigned char* rb = vl + (4 * hi + q) * VRS + (16 * g + 4 * pp) * 2;
#pragma unroll
    for (int ks = 0; ks < 2; ++ks) {
        v4u pw; pw.x = cvtpk(p[8 * ks + 0], p[8 * ks + 1]); pw.y = cvtpk(p[8 * ks + 2], p[8 * ks + 3]); pw.z = cvtpk(p[8 * ks + 4], p[8 * ks + 5]); pw.w = cvtpk(p[8 * ks + 6], p[8 * ks + 7]);
        const bf16x8 pf = __builtin_bit_cast(bf16x8, pw);
#pragma unroll
        for (int d0 = 0; d0 < 2; ++d0) {
            const v4i16 lo = __builtin_amdgcn_ds_read_tr16_b64_v4i16((LAS v4i16*)(rb + (16 * ks) * VRS + d0 * 64));
            const v4i16 hh = __builtin_amdgcn_ds_read_tr16_b64_v4i16((LAS v4i16*)(rb + (16 * ks + 8) * VRS + d0 * 64));
            const bf16x8 vf = (bf16x8){lo[0], lo[1], lo[2], lo[3], hh[0], hh[1], hh[2], hh[3]};
            o[d0] = __builtin_amdgcn_mfma_f32_32x32x16_bf16(vf, pf, o[d0], 0, 0, 0);
        }
    }
}
__device__ __forceinline__ void store_o(const f32x16 (&o)[2], float inv, bf16* yrow, int lane) {
    const int hi = lane >> 5;
#pragma unroll
    for (int d0 = 0; d0 < 2; ++d0)
#pragma unroll
        for (int G = 0; G < 4; ++G) { v2u w; w.x = cvtpk(o[d0][4 * G] * inv, o[d0][4 * G + 1] * inv); w.y = cvtpk(o[d0][4 * G + 2] * inv, o[d0][4 * G + 3] * inv);
            *(GAS v2u*)(yrow + 32 * d0 + 8 * G + 4 * hi) = w; }
}
__device__ __forceinline__ void softmax_tile(f32x16& x, float& m, float& l, f32x16 (&o)[2]) {
    float tm = x[0];
#pragma unroll
    for (int r = 1; r < 16; ++r) tm = fmaxf(tm, x[r]);
    tm = fmaxf(tm, __shfl_xor(tm, 32));
    float mn = fmaxf(m, tm);
    const float mref = (mn == -INFINITY) ? 0.f : mn;
    const float alpha = ex2(m - mref);
    float ps = 0.f;
#pragma unroll
    for (int r = 0; r < 16; ++r) { x[r] = ex2(x[r] - mref); ps += x[r]; }
    l = l * alpha + ps;
#pragma unroll
    for (int d0 = 0; d0 < 2; ++d0)
#pragma unroll
        for (int r = 0; r < 16; ++r) o[d0][r] *= alpha;
    m = mn;
}
#define CREG(r) (((r) & 3) + 8 * ((r) >> 2))

__device__ __forceinline__ void swa_unit(const bf16* qkv  , bf16* yseq  , int hq, int q0, float slope2, float sink2, LAS unsigned char* vl, int lane) {
    const int hi = lane >> 5, tq = q0 + (lane & 31);
    const bf16* Kb = qkv + C_KC + (hq >> 2) * 64; const bf16* Vb = qkv + C_VC + (hq >> 2) * 64;
    bf16x8 qf[4]; load_q(qf, qkv + C_QC + hq * 64, q0, lane);
    f32x16 o[2];
#pragma unroll
    for (int r = 0; r < 16; ++r) { o[0][r] = 0.f; o[1][r] = 0.f; }
    float m = -INFINITY, l = 0.f;
    KV cur, nxt; int s0 = q0; load_kv(cur, Kb, Vb, s0, lane);
    for (int it = 0; it < 5; ++it) {
        const int s1 = s0 - 32; const bool has = (it < 4) && (s1 >= 0);
        if (has) load_kv(nxt, Kb, Vb, s1, lane);
        f32x16 x = qk_tile(cur, qf);
        const int base = tq - s0 - 4 * hi;
#pragma unroll
        for (int r = 0; r < 16; ++r) { const int dist = base - CREG(r); x[r] = (dist >= 0 && dist < 128) ? (x[r] - slope2 * (float)dist) : -INFINITY; }
        softmax_tile(x, m, l, o);
        pv_tile(o, cur, x, vl, lane);
        if (!has) break;
        cur = nxt; s0 = s1;
    }
    l += __shfl_xor(l, 32);
    const float inv = 1.0f / (l + ex2(sink2 - m));
    store_o(o, inv, yseq + (size_t)tq * 2048 + 1024 + hq * 64, lane);
}

__device__ __forceinline__ void sb_unit(const bf16* qkv, bf16* yseq, int h, int q0, LAS unsigned char* vl, int lane) {
    const int hi = lane >> 5, tq = q0 + (lane & 31);
    const bf16* Kb = qkv + C_KB + h * 64; const bf16* Vb = qkv + C_VB + h * 64;
    bf16x8 qf[4]; load_q(qf, qkv + C_QB + h * 64, q0, lane);
    f32x16 o[2];
#pragma unroll
    for (int r = 0; r < 16; ++r) { o[0][r] = 0.f; o[1][r] = 0.f; }
    float R = 0.f;
    KV cur, nxt; int s0 = q0; load_kv(cur, Kb, Vb, s0, lane);
    for (;;) {
        const int s1 = s0 - 32; const bool has = (s1 >= 0);
        if (has) load_kv(nxt, Kb, Vb, s1, lane);
        f32x16 x = qk_tile(cur, qf);
        const int base = tq - s0 - 4 * hi;
        float L[16];
#pragma unroll
        for (int r = 0; r < 16; ++r) { const float z = x[r]; const float sp = fmaxf(z, 0.f) + lg2(1.0f + ex2(-fabsf(z)));
            const bool valid = (base - CREG(r)) > 0; L[r] = valid ? -sp : 0.f; x[r] = valid ? (z - sp) : -INFINITY; }
        float T[4], To[4], ag[4];
#pragma unroll
        for (int G = 0; G < 4; ++G) T[G] = (L[4 * G] + L[4 * G + 1]) + (L[4 * G + 2] + L[4 * G + 3]);
#pragma unroll
        for (int G = 0; G < 4; ++G) To[G] = __shfl_xor(T[G], 32);
        float run = R;
#pragma unroll
        for (int G = 3; G >= 0; --G) { ag[G] = run + (hi == 0 ? To[G] : 0.f); run += T[G] + To[G]; }
        R = run;
#pragma unroll
        for (int G = 0; G < 4; ++G) { const float s2 = L[4 * G + 3], s1_ = s2 + L[4 * G + 2], s0_ = s1_ + L[4 * G + 1];
            x[4 * G + 3] = ex2(x[4 * G + 3] + ag[G]); x[4 * G + 2] = ex2(x[4 * G + 2] + ag[G] + s2); x[4 * G + 1] = ex2(x[4 * G + 1] + ag[G] + s1_); x[4 * G] = ex2(x[4 * G] + ag[G] + s0_); }
        pv_tile(o, cur, x, vl, lane);
        if (!has) break;
        if (__all(R < -40.0f)) break;
        cur = nxt; s0 = s1;
    }
    store_o(o, 1.0f, yseq + (size_t)tq * 2048 + 512 + h * 64, lane);
}

__device__ __forceinline__ void moba_unit(const bf16* qkv, bf16* yseq, const float* kmean  , int h, int q0, float slope2, LAS unsigned char* vl, int lane) {
    const int hi = lane >> 5, tq = q0 + (lane & 31);
    const int n = __builtin_amdgcn_readfirstlane(q0 >> 8), itd = __builtin_amdgcn_readfirstlane(q0 >> 5);
    const bf16* Kb = qkv + C_KA + h * 64; const bf16* Vb = qkv + C_VA + h * 64;
    bf16x8 qf[4]; load_q(qf, qkv + C_QA + h * 64, q0, lane);
    unsigned sel = 0u;
    if (n > 0) {
        float v0 = -INFINITY, v1 = -INFINITY, v2 = -INFINITY; int i0 = 0, i1 = 0, i2 = 0;
        for (int j = 0; j < n; ++j) {
            const float* km = kmean + j * 64 + 8 * hi; float part = 0.f;
#pragma unroll
            for (int ds = 0; ds < 4; ++ds) { const f32x4 ka = *(const GAS f32x4*)(km + 16 * ds), kb = *(const GAS f32x4*)(km + 16 * ds + 4); const v4u qw = __builtin_bit_cast(v4u, qf[ds]);
                part += bflo(qw.x) * ka.x + bfhi(qw.x) * ka.y + bflo(qw.y) * ka.z + bfhi(qw.y) * ka.w + bflo(qw.z) * kb.x + bfhi(qw.z) * kb.y + bflo(qw.w) * kb.z + bfhi(qw.w) * kb.w; }
            const float gsc = part + __shfl_xor(part, 32);
            if (gsc > v0) { v2 = v1; i2 = i1; v1 = v0; i1 = i0; v0 = gsc; i0 = j; }
            else if (gsc > v1) { v2 = v1; i2 = i1; v1 = gsc; i1 = j; }
            else if (gsc > v2) { v2 = gsc; i2 = j; }
        }
        sel = (n >= 3) ? ((1u << i0) | (1u << i1) | (1u << i2)) : ((1u << n) - 1u);
    }
    unsigned anym = 0u;
    for (int j = 0; j < n; ++j) if (__any((int)((sel >> j) & 1u))) anym |= (1u << j);
    anym = __builtin_amdgcn_readfirstlane(anym);
    f32x16 o[2];
#pragma unroll
    for (int r = 0; r < 16; ++r) { o[0][r] = 0.f; o[1][r] = 0.f; }
    float m = -INFINITY, l = 0.f;
    int own_t = itd; const int own_end = 8 * n; unsigned rem = anym; int pj = -1, ptt = 8;
    KV cur, nxt; int s0 = 32 * itd, cj = -1; load_kv(cur, Kb, Vb, s0, lane);
    for (;;) {
        int s1 = 0, nj = -1; bool has = true;
        if (own_t > own_end) { --own_t; s1 = 32 * own_t; nj = -1; }
        else { own_t = -1;
            if (ptt >= 8) { if (rem == 0u) has = false; else { pj = __builtin_ctz(rem); rem &= rem - 1u; ptt = 0; } }
            if (has) { s1 = 256 * pj + 32 * ptt; nj = pj; ++ptt; } }
        if (has) load_kv(nxt, Kb, Vb, s1, lane);
        f32x16 x = qk_tile(cur, qf);
        const int base = tq - s0 - 4 * hi;
        const bool lane_ok = (cj < 0) ? true : (((sel >> cj) & 1u) != 0u);
#pragma unroll
        for (int r = 0; r < 16; ++r) { const int dist = base - CREG(r); x[r] = (lane_ok && dist >= 0) ? (x[r] - slope2 * (float)dist) : -INFINITY; }
        softmax_tile(x, m, l, o);
        pv_tile(o, cur, x, vl, lane);
        if (!has) break;
        cur = nxt; s0 = s1; cj = nj;
    }
    l += __shfl_xor(l, 32);
    store_o(o, 1.0f / l, yseq + (size_t)tq * 2048 + h * 64, lane);
}
}

struct Args { const float* in[16]; float* out; unsigned char* ws; int ph_lo, ph_hi, use_bar, pad; };
typedef const __attribute__((address_space(4))) Args* CArgsP;
__device__ __forceinline__ CArgsP kargs() { CArgsP p = (CArgsP)__builtin_amdgcn_kernarg_segment_ptr(); asm volatile("" : "+s"(p)); return p; }
constexpr int N_PHASES = 4 * 3 + DEPTH * (1 + NCHUNK * 6) + 1;

__global__ void __launch_bounds__(NWAVES * 64, 2) fwd_kernel(Args args) {
    extern __shared__ __attribute__((aligned(16))) unsigned char lds_raw[];
    LAS unsigned char* lds = (LAS unsigned char*)lds_raw;
    volatile LAS unsigned* MISC = (volatile LAS unsigned*)(lds + MISC_OFF);
    const int G = gridDim.x; const int bx = blockIdx.x; const int vcu = (G % 8 == 0) ? (bx % 8) * (G / 8) + bx / 8 : bx;
    const int NGW = G * NWAVES;
#define PH_LOCALS int tid = threadIdx.x; asm volatile("" : "+v"(tid)); const int lane = tid & 63, wave = __builtin_amdgcn_readfirstlane(tid >> 6), gw = vcu * NWAVES + wave; (void)lane; (void)gw;
    for (int u = threadIdx.x; u < (LDS_BYTES - LDSCTL_OFF) / 4; u += NWAVES * 64) ((LAS unsigned*)(lds + LDSCTL_OFF))[u] = 0u;
    __syncthreads();
    { CArgsP A0 = kargs(); if (A0->use_bar) (void)xcd_barrier_post((unsigned*)(A0->ws + WS_CTL) + CW_BAR, MISC + 8); }
    int lo, hi_ph; { CArgsP A0 = kargs(); lo = A0->ph_lo; hi_ph = A0->ph_hi; }
    int ph = 0;
#define PH_ON (ph >= lo && ph < hi_ph)
#define PH_END do { if ((ph + 1) < hi_ph && ph >= lo) { CArgsP Ab = kargs(); if (Ab->use_bar) { XcdBarrier bar_; bar_.bar = (unsigned*)(Ab->ws + WS_CTL) + CW_BAR; bar_.x = xb_xcc_id(); bar_.st = MISC + 8; xcd_barrier(bar_); } } ++ph; } while (0)
#define WSP(T, off) ((T*)(A->ws + (off)))

#pragma unroll 1
    for (int fi = 0; fi < 2 * DEPTH; ++fi) {
        const int layer = fi >> 1, second = fi & 1;
        if (PH_ON) {
            CArgsP A = kargs(); PH_LOCALS
            if (!second) {
                LAS float* scr = (LAS float*)(lds + wave * 16384);
                constexpr int I13 = (2048 / 64) * (11264 / 32), I2 = (5632 / 64) * (2048 / 32), IQ = (2048 / 64) * (QKV_W / 32), IG = (2048 / 64) * (8192 / 32), IB = (512 / 64) * (8192 / 32), IO = (2048 / 64) * (2048 / 32);
                constexpr int NIT = 2 * I13 + 2 * I2 + IQ + IG + IB + IO;
                const size_t offF = (size_t)layer * D_MODEL * D_FF;
#pragma unroll 1
                for (int it = gw; it < NIT; it += NGW) {
                    int r = it; int kind, c0 = 0, ldw, K, nrows; const float* W; const float* W2 = nullptr; bf16* WT;
                    if (r < I13) { kind = 1; W = A->in[2] + offF; W2 = A->in[3] + offF; ldw = D_FF; K = 2048; nrows = 11264; WT = WSP(bf16, WS_W13A); }
                    else if ((r -= I13) < I13) { kind = 1; W = A->in[12] + offF; W2 = A->in[13] + offF; ldw = D_FF; K = 2048; nrows = 11264; WT = WSP(bf16, WS_W13B); }
                    else if ((r -= I13) < I2) { kind = 0; W = A->in[4] + offF; ldw = D_MODEL; K = 5632; nrows = 2048; WT = WSP(bf16, WS_W2A); }
                    else if ((r -= I2) < I2) { kind = 0; W = A->in[14] + offF; ldw = D_MODEL; K = 5632; nrows = 2048; WT = WSP(bf16, WS_W2B); }
                    else if ((r -= I2) < IQ) { kind = 0; W = A->in[6] + (size_t)layer * D_MODEL * IN_COLS; ldw = IN_COLS; K = 2048; nrows = QKV_W; WT = WSP(bf16, WS_WQKV); }
                    else if ((r -= IQ) < IG) { kind = 2; W = A->in[6] + (size_t)layer * D_MODEL * IN_COLS; c0 = QKV_W; ldw = IN_COLS; K = 2048; nrows = 8192; WT = WSP(bf16, WS_WG); }
                    else if ((r -= IG) < IB) { kind = 3; W = A->in[9] + (size_t)layer * 4 * 512 * D_MODEL; ldw = D_MODEL; K = 512; nrows = 8192; WT = WSP(bf16, WS_WB); }
                    else { r -= IB; kind = 0; W = A->in[10] + (size_t)layer * D_MODEL * D_MODEL; ldw = D_MODEL; K = 2048; nrows = 2048; WT = WSP(bf16, WS_WO); }
                    transpose_item(kind, W, W2, c0, ldw, K, nrows, WT, scr, r, lane);
                }
            }
            const float* gnorm = (second ? A->in[11] : A->in[1]) + (size_t)layer * D_MODEL;
            const float* hsrc = (fi == 0) ? A->in[0] : A->out;
            bf16* XN = WSP(bf16, WS_XN);
#pragma unroll 1
            for (int mrow = gw; mrow < MTOK; mrow += NGW) rms_row_to_bf16(hsrc + (size_t)mrow * D_MODEL, gnorm, XN + (size_t)mrow * D_MODEL, lane);
        }
        PH_END;
        if (PH_ON) {
            CArgsP A = kargs(); PH_LOCALS
            pg8::Gemm g{WSP(bf16, WS_XN), second ? WSP(bf16, WS_W13B) : WSP(bf16, WS_W13A), MTOK, 2 * D_FF, D_MODEL, D_MODEL, 0, 0}; pg8::StaticOrder S; S.init(MTOK, 2 * D_FF, G, bx);
            pg8::EpiSwiglu E{WSP(bf16, WS_U), D_FF};
            pg8::gemm_phase<pg8::EpiSwiglu, pg8::StaticOrder>(lds, g, S, E, tid);
        }
        PH_END;
        if (PH_ON) {
            CArgsP A = kargs(); PH_LOCALS
            pg8::Gemm g{WSP(bf16, WS_U), second ? WSP(bf16, WS_W2B) : WSP(bf16, WS_W2A), MTOK, D_MODEL, D_FF, D_FF, 0, 0}; pg8::StaticOrder S; S.init(MTOK, D_MODEL, G, bx);
            pg8::EpiResid E{(fi == 0) ? A->in[0] : (const float*)A->out, A->out, D_MODEL, 0.5f};
            pg8::gemm_phase<pg8::EpiResid, pg8::StaticOrder>(lds, g, S, E, tid);
        }
        PH_END;
        if (second) continue;
        if (PH_ON) {
            CArgsP A = kargs(); PH_LOCALS
            const float* gmix = A->in[5] + (size_t)layer * D_MODEL; const float* hsrc = A->out; bf16* XN = WSP(bf16, WS_XN);
#pragma unroll 1
            for (int mrow = gw; mrow < MTOK; mrow += NGW) rms_row_to_bf16(hsrc + (size_t)mrow * D_MODEL, gmix, XN + (size_t)mrow * D_MODEL, lane);
        }
        PH_END;
#pragma unroll 1
        for (int ch = 0; ch < NCHUNK; ++ch) {
            if (PH_ON) {
                CArgsP A = kargs(); PH_LOCALS
                pg8::Gemm g{WSP(bf16, WS_XN) + (size_t)ch * CH_ROWS * D_MODEL, WSP(bf16, WS_WQKV), CH_ROWS, QKV_W, D_MODEL, D_MODEL, 0, 0}; pg8::StaticOrder S; S.init(CH_ROWS, QKV_W, G, bx);
                pg8::EpiBf16 E{WSP(bf16, WS_QKV), QKV_W, QMASK, QSCALE};
                pg8::gemm_phase<pg8::EpiBf16, pg8::StaticOrder>(lds, g, S, E, tid);
            }
            PH_END;
            if (PH_ON) {
                CArgsP A = kargs(); PH_LOCALS
                const bf16* QKV = WSP(bf16, WS_QKV); float* KMEAN = WSP(float, WS_KMEAN);
#pragma unroll 1
                for (int it = gw; it < CH_B * 8 * 16; it += NGW) {
                    const int blk = it & 15, h = (it >> 4) & 7, b = it >> 7;
                    const bf16* kp = QKV + ((size_t)b * SEQ + blk * 256 + (lane >> 3)) * QKV_W + C_KA + h * 64 + (lane & 7) * 8;
                    float a[8];
#pragma unroll
                    for (int j = 0; j < 8; ++j) a[j] = 0.f;
#pragma unroll 8
                    for (int i = 0; i < 32; ++i) { const v4u w = *(const GAS v4u*)(kp + (size_t)(8 * i) * QKV_W);
                        a[0] += bflo(w.x); a[1] += bfhi(w.x); a[2] += bflo(w.y); a[3] += bfhi(w.y); a[4] += bflo(w.z); a[5] += bfhi(w.z); a[6] += bflo(w.w); a[7] += bfhi(w.w); }
#pragma unroll
                    for (int j = 0; j < 8; ++j) { a[j] += __shfl_xor(a[j], 8); a[j] += __shfl_xor(a[j], 16); a[j] += __shfl_xor(a[j], 32); }
                    if (lane < 8) { float* kmo = KMEAN + (size_t)it * 64 + lane * 8;
                        *(f32x4*)kmo = (f32x4){a[0], a[1], a[2], a[3]} * (1.f / 256.f); *(f32x4*)(kmo + 4) = (f32x4){a[4], a[5], a[6], a[7]} * (1.f / 256.f); }
                }
            }
            PH_END;
            if (PH_ON) {
                CArgsP A = kargs(); PH_LOCALS
                const bf16* QKV = WSP(bf16, WS_QKV); bf16* YB = WSP(bf16, WS_Y);
                LAS unsigned char* vl = lds + wave * 8192;
                const int bh = gw >> 6, k = gw & 63;
                if (NGW == 2048) {
                    const int b = bh >> 3, h = bh & 7;
                    const bf16* qseq = QKV + (size_t)b * SEQ * QKV_W; bf16* yseq = YB + (size_t)b * SEQ * 2048;
                    const float msl = exp2f(-8.0f * (float)(8 + h + 1) / 16.0f) * 1.4426950408889634f;
                    const float ssl = exp2f(-8.0f * (float)(h + 1) / 16.0f) * 1.4426950408889634f;
                    const float* km = WSP(float, WS_KMEAN) + (size_t)bh * 16 * 64;
#pragma unroll 1
                    for (int rep = 0; rep < 2; ++rep) { const int qt = rep ? (127 - k) : k; att::moba_unit(qseq, yseq, km, h, 32 * qt, msl, vl, lane); }
#pragma unroll 1
                    for (int rep = 0; rep < 2; ++rep) { const int qt = rep ? (127 - k) : k; att::sb_unit(qseq, yseq, h, 32 * qt, vl, lane); }
                    const float sk2 = (A->in[8] + (size_t)layer * 8)[h] * 1.4426950408889634f;
#pragma unroll 1
                    for (int rep = 0; rep < 2; ++rep) { const int qt = rep ? (127 - k) : k; att::swa_unit(qseq, yseq, h, 32 * qt, ssl, sk2, vl, lane); }
                }
                const float* convw = A->in[7] + (size_t)layer * 3 * 512;
#pragma unroll 1
                for (int idx = gw * 64 + lane; idx < CH_ROWS * 64; idx += NGW * 64) {
                    const int row = idx >> 6, c0 = (idx & 63) * 8, t = row & (SEQ - 1);
                    const bf16* rp = QKV + (size_t)row * QKV_W;
                    float accv[8];
#pragma unroll
                    for (int j = 0; j < 8; ++j) accv[j] = 0.f;
#pragma unroll
                    for (int dt = 0; dt < 3; ++dt) {
                        if (t - dt >= 0) {
                            const v4u cgw = *(const GAS v4u*)(rp - (size_t)dt * QKV_W + C_CG + c0), hdw = *(const GAS v4u*)(rp - (size_t)dt * QKV_W + C_HD + c0);
                            const float* wk = convw + (2 - dt) * 512 + c0; const f32x4 wa = *(const GAS f32x4*)wk, wb = *(const GAS f32x4*)(wk + 4);
                            accv[0] += wa.x * bflo(cgw.x) * bflo(hdw.x); accv[1] += wa.y * bfhi(cgw.x) * bfhi(hdw.x); accv[2] += wa.z * bflo(cgw.y) * bflo(hdw.y); accv[3] += wa.w * bfhi(cgw.y) * bfhi(hdw.y);
                            accv[4] += wb.x * bflo(cgw.z) * bflo(hdw.z); accv[5] += wb.y * bfhi(cgw.z) * bfhi(hdw.z); accv[6] += wb.z * bflo(cgw.w) * bflo(hdw.w); accv[7] += wb.w * bfhi(cgw.w) * bfhi(hdw.w);
                        }
                    }
                    const v4u bgw = *(const GAS v4u*)(rp + C_BG + c0);
                    v4u o; o.x = pk2(accv[0] * bflo(bgw.x), accv[1] * bfhi(bgw.x)); o.y = pk2(accv[2] * bflo(bgw.y), accv[3] * bfhi(bgw.y));
                    o.z = pk2(accv[4] * bflo(bgw.z), accv[5] * bfhi(bgw.z)); o.w = pk2(accv[6] * bflo(bgw.w), accv[7] * bfhi(bgw.w));
                    *(GAS v4u*)(YB + (size_t)row * 2048 + 1536 + c0) = o;
                }
            }
            PH_END;
            if (PH_ON) {
                CArgsP A = kargs(); PH_LOCALS
                pg8::Gemm g{WSP(bf16, WS_Y), WSP(bf16, WS_WB), CH_ROWS, 8192, 512, 2048, 8, 512}; pg8::StaticOrder S; S.init(CH_ROWS, 8192, G, bx);
                pg8::EpiBf16 E{WSP(bf16, WS_P), 8192, 0u, 1.0f};
                pg8::gemm_phase<pg8::EpiBf16, pg8::StaticOrder>(lds, g, S, E, tid);
            }
            PH_END;
            if (PH_ON) {
                CArgsP A = kargs(); PH_LOCALS
                pg8::Gemm g{WSP(bf16, WS_XN) + (size_t)ch * CH_ROWS * D_MODEL, WSP(bf16, WS_WG), CH_ROWS, 8192, D_MODEL, D_MODEL, 0, 0}; pg8::StaticOrder S; S.init(CH_ROWS, 8192, G, bx);
                pg8::EpiGateMerge E{WSP(bf16, WS_P), WSP(bf16, WS_MG)};
                pg8::gemm_phase<pg8::EpiGateMerge, pg8::StaticOrder>(lds, g, S, E, tid);
            }
            PH_END;
            if (PH_ON) {
                CArgsP A = kargs(); PH_LOCALS
                float* hc = A->out + (size_t)ch * CH_ROWS * D_MODEL;
                pg8::Gemm g{WSP(bf16, WS_MG), WSP(bf16, WS_WO), CH_ROWS, D_MODEL, D_MODEL, D_MODEL, 0, 0}; pg8::StaticOrder S; S.init(CH_ROWS, D_MODEL, G, bx);
                pg8::EpiResid E{hc, hc, D_MODEL, 1.0f};
                pg8::gemm_phase<pg8::EpiResid, pg8::StaticOrder>(lds, g, S, E, tid);
            }
            PH_END;
        }
    }
    if (PH_ON) { CArgsP A = kargs(); PH_LOCALS const float* gfin = A->in[15]; float* hb = A->out;
#pragma unroll 1
        for (int mrow = gw; mrow < MTOK; mrow += NGW) rms_row_to_f32(hb + (size_t)mrow * D_MODEL, gfin, lane); }
#undef PH_ON
#undef PH_END
#undef WSP
#undef PH_LOCALS
}

extern "C" void kernel_launch(void* const* d_in, const int* in_sizes, int n_in, void* d_out, int out_size, void* d_ws, size_t ws_size, hipStream_t stream) {
    static int grid = 0;
    if (grid == 0) {
        if (n_in != 16 || in_sizes[0] != MTOK * D_MODEL || out_size != MTOK * D_MODEL || ws_size < WS_END) {
            fprintf(stderr, "kernel_launch: unexpected problem (n_in %d, in0 %d, out %d, ws %zu; need ws >= %zu); nothing launched\n", n_in, n_in > 0 ? in_sizes[0] : -1, out_size, ws_size, (size_t)WS_END); grid = -1; return; }
        int dev = 0, cus = 0, per_cu = 0;
        if (hipGetDevice(&dev) != hipSuccess || hipDeviceGetAttribute(&cus, hipDeviceAttributeMultiprocessorCount, dev) != hipSuccess) { grid = -1; return; }
        if (hipFuncSetAttribute((const void*)fwd_kernel, hipFuncAttributeMaxDynamicSharedMemorySize, LDS_BYTES) != hipSuccess) { fprintf(stderr, "kernel_launch: hipFuncSetAttribute failed\n"); grid = -1; return; }
        if (hipOccupancyMaxActiveBlocksPerMultiprocessor(&per_cu, (const void*)fwd_kernel, NWAVES * 64, LDS_BYTES) != hipSuccess || per_cu < 1)
            fprintf(stderr, "kernel_launch: note: occupancy query reports %d workgroups per CU\n", per_cu);
        (void)hipGetLastError();
        grid = cus;
    }
    if (grid < 0) return;
    if (hipMemsetAsync((char*)d_ws + WS_CTL, 0, CTL_ZERO_BYTES, stream) != hipSuccess) return;
    Args a{};
    for (int i = 0; i < 16; ++i) a.in[i] = (const float*)d_in[i];
    a.out = (float*)d_out; a.ws = (unsigned char*)d_ws; a.pad = 0;
#if MK_PER_PHASE
    for (int p = 0; p < N_PHASES; ++p) { a.ph_lo = p; a.ph_hi = p + 1; a.use_bar = 0; hipLaunchKernelGGL(fwd_kernel, dim3(grid), dim3(NWAVES * 64), LDS_BYTES, stream, a); }
#else
    a.ph_lo = 0; a.ph_hi = N_PHASES; a.use_bar = 1;
    hipLaunchKernelGGL(fwd_kernel, dim3(grid), dim3(NWAVES * 64), LDS_BYTES, stream, a);
#endif
    const hipError_t le = hipPeekAtLastError();
    if (le != hipSuccess) fprintf(stderr, "kernel_launch: launch failed: %s\n", hipGetErrorName(le));
}
```
